# Optimizing an MI355X kernel written in HIP

```python
import math
import jax, jax.numpy as jnp
from jax import lax
import numpy as np

D_MODEL = 1024
BATCH = 4
SEQ = 4096
DEPTH = 2

N_HEADS = 16
HEAD_DIM = 64
MIX_WIDTH = N_HEADS * HEAD_DIM
N_MIXERS = 2
SB_Q_BLOCK = 128
MOBA_BLOCK = 256
MOBA_TOPK = 3
MOBA_Q_CHUNK = 32
REL_BUCKETS = 32
REL_MAX_DIST = 128
LN_EPS = 1e-5
DEEPNORM_ALPHA = (2.0 * DEPTH) ** 0.25
DEEPNORM_BETA = (8.0 * DEPTH) ** -0.25
NEG_INF = -1e30

kernel_name = "hybrid_stickbreak_moba_deepnorm"


def layer_norm(x, g, b):
    xf = x.astype(jnp.float32)
    mu = jnp.mean(xf, axis=-1, keepdims=True)
    var = jnp.mean(jnp.square(xf - mu), axis=-1, keepdims=True)
    y = (xf - mu) * lax.rsqrt(var + LN_EPS) * g.astype(jnp.float32) + b.astype(jnp.float32)
    return y.astype(x.dtype)


def t5_bucket(dist):
    n = jnp.maximum(dist, 0)
    max_exact = REL_BUCKETS // 2
    nf = jnp.maximum(n, 1).astype(jnp.float32)
    large = max_exact + (jnp.log(nf / max_exact) / math.log(REL_MAX_DIST / max_exact)
                         * (REL_BUCKETS - max_exact)).astype(jnp.int32)
    large = jnp.minimum(large, REL_BUCKETS - 1)
    return jnp.where(n < max_exact, n, large)


def split_heads(t):
    B, S, _ = t.shape
    return t.reshape(B, S, N_HEADS, HEAD_DIM).transpose(0, 2, 1, 3)


def stick_breaking_attention(q, k, v):
    S = q.shape[2]
    scale = HEAD_DIM ** -0.5
    outs = []
    for blk in range(S // SB_Q_BLOCK):
        q0 = blk * SB_Q_BLOCK
        q1 = q0 + SB_Q_BLOCK
        qb = q[:, :, q0:q1]
        kb = k[:, :, :q1]
        vb = v[:, :, :q1]
        z = jnp.einsum('bhqd,bhkd->bhqk', qb, kb).astype(jnp.float32) * scale
        past = jnp.arange(q1)[None, :] < jnp.arange(q0, q1)[:, None]
        log_1mb = jnp.where(past, jax.nn.log_sigmoid(-z), 0.0)
        rev_cs = lax.cumsum(log_1mb, axis=log_1mb.ndim - 1, reverse=True)
        log_w = jax.nn.log_sigmoid(z) + rev_cs - log_1mb
        w = jnp.where(past, jnp.exp(log_w), 0.0)
        outs.append(jnp.einsum('bhqk,bhkd->bhqd', w.astype(v.dtype), vb))
    return jnp.concatenate(outs, axis=2)


def moba_attention(q, k, v, rel_table):
    B, H, S, Dh = q.shape
    scale = Dh ** -0.5
    nb = -(-S // MOBA_BLOCK)
    pad = nb * MOBA_BLOCK - S
    kp = jnp.pad(k, ((0, 0), (0, 0), (0, pad), (0, 0)))
    vp = jnp.pad(v, ((0, 0), (0, 0), (0, pad), (0, 0)))
    k_blocks = kp.reshape(B, H, nb, MOBA_BLOCK, Dh)
    v_blocks = vp.reshape(B, H, nb, MOBA_BLOCK, Dh)
    k_mean = jnp.mean(k_blocks.astype(jnp.float32), axis=3)

    pos = jnp.arange(S, dtype=jnp.int32)
    own = pos // MOBA_BLOCK
    gate = jnp.einsum('bhsd,bhnd->bhsn', q.astype(jnp.float32), k_mean)
    past_block = jnp.arange(nb)[None, :] < own[:, None]
    gate = jnp.where(past_block, gate, NEG_INF)
    kk = min(MOBA_TOPK, nb)
    _, top_idx = lax.top_k(gate, kk)
    top_ok = jnp.arange(kk)[None, :] < jnp.minimum(own, MOBA_TOPK)[:, None]
    own_idx = jnp.broadcast_to(own[None, None, :, None], (B, H, S, 1))
    sel_idx = jnp.concatenate([top_idx.astype(jnp.int32), own_idx], axis=-1)
    slot_ok = jnp.concatenate([top_ok, jnp.ones((S, 1), dtype=bool)], axis=-1)
    J = kk + 1

    nc = S // MOBA_Q_CHUNK
    C = MOBA_Q_CHUNK
    q_c = jnp.moveaxis(q.reshape(B, H, nc, C, Dh), 2, 0)
    idx_c = jnp.moveaxis(sel_idx.reshape(B, H, nc, C, J), 2, 0)
    ok_c = slot_ok.reshape(nc, C, J)
    qpos_c = pos.reshape(nc, C)
    bi = jnp.arange(B)[:, None, None, None]
    hi = jnp.arange(H)[None, :, None, None]
    hi5 = jnp.arange(H)[None, :, None, None, None]
    offs = jnp.arange(MOBA_BLOCK, dtype=jnp.int32)

    def chunk_fn(args):
        qc, idxc, okc, qposc = args
        kg = k_blocks[bi, hi, idxc]
        vg = v_blocks[bi, hi, idxc]
        kpos = idxc[..., None] * MOBA_BLOCK + offs
        dist = qposc[None, None, :, None, None] - kpos
        valid = okc[None, None, :, :, None] & (dist >= 0)
        bias = rel_table[t5_bucket(dist), hi5].astype(jnp.float32)
        logits = jnp.einsum('bhcd,bhcjld->bhcjl', qc, kg).astype(jnp.float32) * scale + bias
        logits = jnp.where(valid, logits, NEG_INF).reshape(B, H, C, J * MOBA_BLOCK)
        p = jax.nn.softmax(logits, axis=-1).reshape(B, H, C, J, MOBA_BLOCK)
        return jnp.einsum('bhcjl,bhcjld->bhcd', p.astype(vg.dtype), vg)

    out = lax.map(chunk_fn, (q_c, idx_c, ok_c, qpos_c))
    return jnp.moveaxis(out, 0, 2).reshape(B, H, S, Dh)


def hybrid_layer(x, w_in, w_out, ln_g, ln_b, rel_table, mixer_id):
    B, S, _ = x.shape
    proj = jnp.einsum('bsd,de->bse', x, w_in)
    q, k, v, g = jnp.split(proj, 4, axis=-1)
    q, k, v = split_heads(q), split_heads(k), split_heads(v)
    if mixer_id == 0:
        o = stick_breaking_attention(q, k, v)
    else:
        o = moba_attention(q, k, v, rel_table)
    o = o.transpose(0, 2, 1, 3).reshape(B, S, MIX_WIDTH)
    y = jnp.einsum('bse,ed->bsd', o * jax.nn.silu(g), w_out)
    return layer_norm(DEEPNORM_ALPHA * x + y, ln_g, ln_b)


def setup_inputs(seed: int = 0) -> dict:
    key = jax.random.key(seed)
    kx, kin, kout, kg, kb, kr = jax.random.split(key, 6)
    x = jax.random.normal(kx, (BATCH, SEQ, D_MODEL), jnp.float32)
    w_in = jax.random.normal(kin, (DEPTH, D_MODEL, 4 * MIX_WIDTH), jnp.float32) * D_MODEL ** -0.5
    w_out = (jax.random.normal(kout, (DEPTH, MIX_WIDTH, D_MODEL), jnp.float32)
             * MIX_WIDTH ** -0.5 * DEEPNORM_BETA)
    ln_g = 1.0 + 0.02 * jax.random.normal(kg, (DEPTH, D_MODEL), jnp.float32)
    ln_b = 0.02 * jax.random.normal(kb, (DEPTH, D_MODEL), jnp.float32)
    rel_table = 0.2 * jax.random.normal(kr, (REL_BUCKETS, N_HEADS), jnp.float32)
    return {"x": x, "w_in": w_in, "w_out": w_out, "ln_g": ln_g, "ln_b": ln_b,
            "rel_table": rel_table}


def reference(x, w_in, w_out, ln_g, ln_b, rel_table):
    h = x
    for layer in range(DEPTH):
        h = hybrid_layer(h, w_in[layer], w_out[layer], ln_g[layer], ln_b[layer],
                         rel_table, layer % N_MIXERS)
    return h
```

```cpp
#include <hip/hip_runtime.h>
#include <cstdint>
#include <cstdio>

constexpr int BATCH = 4, SEQ = 4096, D = 1024, H = 16, HD = 64, M = BATCH * SEQ, NPROJ = 4 * D;
constexpr int MB = 256, NB = SEQ / MB;
constexpr float LN_EPS = 1e-5f, ALPHA = 1.41421356237309515f;
constexpr float LOG2E = 1.4426950408889634f, C2 = 0.125f * LOG2E;
typedef unsigned short bf16;

constexpr size_t MiB = 1u << 20;
constexpr size_t WS_KM = 1 * MiB, WS_WIN0 = 2 * MiB, WS_WIN1 = 10 * MiB, WS_WO0 = 18 * MiB, WS_WO1 = 20 * MiB;
constexpr size_t WS_Q = 32 * MiB, WS_K = 64 * MiB, WS_V = 96 * MiB, WS_G = 128 * MiB, WS_XN = 160 * MiB, WS_O = 192 * MiB;
constexpr size_t WS_Y = 32 * MiB;
constexpr size_t WS_END = 256 * MiB;

__device__ __forceinline__ unsigned f2bf(float f) { unsigned u = __builtin_bit_cast(unsigned, f); return (u + 0x7fffu + ((u >> 16) & 1u)) >> 16; }
__device__ __forceinline__ float bf2f(unsigned short b) { return __builtin_bit_cast(float, (unsigned)b << 16); }

__global__ void k_cvt(const float* __restrict__ x, bf16* __restrict__ o, size_t n4) {
    size_t i = (size_t)blockIdx.x * blockDim.x + threadIdx.x;
    for (; i < n4; i += (size_t)gridDim.x * blockDim.x) {
        float4 v = ((const float4*)x)[i];
        uint2 w; w.x = f2bf(v.x) | (f2bf(v.y) << 16); w.y = f2bf(v.z) | (f2bf(v.w) << 16);
        ((uint2*)o)[i] = w;
    }
}
__global__ void k_transpose(const float* __restrict__ W, int K, int N, bf16* __restrict__ WT) {
    __shared__ float t[32][33];
    const int n0 = blockIdx.x * 32, k0 = blockIdx.y * 32, tx = threadIdx.x & 31, ty = threadIdx.x >> 5;
    for (int i = ty; i < 32; i += 8) t[i][tx] = W[(size_t)(k0 + i) * N + n0 + tx];
    __syncthreads();
    for (int i = ty; i < 32; i += 8) WT[(size_t)(n0 + i) * K + k0 + tx] = (bf16)f2bf(t[tx][i]);
}

template <int MODE>
__global__ void __launch_bounds__(256) k_gemm(const bf16* __restrict__ A, const bf16* __restrict__ Bt, int Mx, int N, int K, bf16* __restrict__ O, size_t tstride, float* __restrict__ Y) {
    __shared__ float As[32][65], Bs[32][65];
    const int m0 = blockIdx.y * 64, n0 = blockIdx.x * 64, tid = threadIdx.x, tx = tid & 15, ty = tid >> 4;
    float acc[4][4] = {};
    for (int k0 = 0; k0 < K; k0 += 32) {
        {
            const int r = tid >> 2, c = (tid & 3) * 8;
            const uint4 va = *(const uint4*)(A + (size_t)(m0 + r) * K + k0 + c);
            const uint4 vb = *(const uint4*)(Bt + (size_t)(n0 + r) * K + k0 + c);
            const unsigned wa[4] = {va.x, va.y, va.z, va.w}, wb[4] = {vb.x, vb.y, vb.z, vb.w};
#pragma unroll
            for (int j = 0; j < 4; ++j) {
                As[c + 2 * j][r] = bf2f((unsigned short)(wa[j] & 0xffff)); As[c + 2 * j + 1][r] = bf2f((unsigned short)(wa[j] >> 16));
                Bs[c + 2 * j][r] = bf2f((unsigned short)(wb[j] & 0xffff)); Bs[c + 2 * j + 1][r] = bf2f((unsigned short)(wb[j] >> 16));
            }
        }
        __syncthreads();
#pragma unroll 8
        for (int k = 0; k < 32; ++k) {
            float a[4], b[4];
#pragma unroll
            for (int i = 0; i < 4; ++i) { a[i] = As[k][ty * 4 + i]; b[i] = Bs[k][tx * 4 + i]; }
#pragma unroll
            for (int i = 0; i < 4; ++i)
#pragma unroll
                for (int j = 0; j < 4; ++j) acc[i][j] += a[i] * b[j];
        }
        __syncthreads();
    }
#pragma unroll
    for (int i = 0; i < 4; ++i) {
        const int m = m0 + ty * 4 + i;
#pragma unroll
        for (int j = 0; j < 4; ++j) {
            const int n = n0 + tx * 4 + j;
            if (MODE == 0) { const int t = n >> 10, c = n & 1023; const float s = (t == 0) ? C2 : 1.f; O[(size_t)t * tstride + (size_t)m * D + c] = (bf16)f2bf(acc[i][j] * s); }
            else Y[(size_t)m * N + n] = acc[i][j];
        }
    }
}

__global__ void k_kmean(const bf16* __restrict__ Kb, float* __restrict__ KM) {
    const int idx = blockIdx.x, n = idx % NB, bh = idx / NB, b = bh / H, h = bh % H, d = threadIdx.x;
    float s = 0.f;
    for (int i = 0; i < MB; ++i) s += bf2f(Kb[(size_t)(b * SEQ + n * MB + i) * D + h * HD + d]);
    KM[(size_t)idx * HD + d] = s * (1.0f / MB);
}

__global__ void __launch_bounds__(256) k_sb(const bf16* __restrict__ Q, const bf16* __restrict__ Kb, const bf16* __restrict__ Vb, const bf16* __restrict__ G, bf16* __restrict__ O) {
    const int blk = blockIdx.x, qb = blk % NB, bh = blk / NB, b = bh / H, h = bh % H;
    const int t = qb * MB + threadIdx.x;
    const size_t rowq = (size_t)(b * SEQ + t) * D + h * HD;
    float q[HD], o[HD];
#pragma unroll
    for (int d = 0; d < HD; ++d) { q[d] = bf2f(Q[rowq + d]); o[d] = 0.f; }
    float c = 0.f;
    for (int s = qb * MB + MB - 2; s >= 0; --s) {
        const size_t rowk = (size_t)(b * SEQ + s) * D + h * HD;
        const uint4* kp = (const uint4*)(Kb + rowk); const uint4* vp = (const uint4*)(Vb + rowk);
        float u = 0.f;
#pragma unroll
        for (int j = 0; j < 8; ++j) { const uint4 kk = kp[j]; const unsigned w[4] = {kk.x, kk.y, kk.z, kk.w};
#pragma unroll
            for (int i = 0; i < 4; ++i) { u += q[8 * j + 2 * i] * bf2f((unsigned short)(w[i] & 0xffff)); u += q[8 * j + 2 * i + 1] * bf2f((unsigned short)(w[i] >> 16)); } }
        if (s < t) {
            const float a = fabsf(u), e = exp2f(-a), lg = log2f(1.f + e), L2 = -(fmaxf(u, 0.f) + lg);
            const float w = exp2f(u + L2 + c); c += L2;
#pragma unroll
            for (int j = 0; j < 8; ++j) { const uint4 vv = vp[j]; const unsigned ww[4] = {vv.x, vv.y, vv.z, vv.w};
#pragma unroll
                for (int i = 0; i < 4; ++i) { o[8 * j + 2 * i] += w * bf2f((unsigned short)(ww[i] & 0xffff)); o[8 * j + 2 * i + 1] += w * bf2f((unsigned short)(ww[i] >> 16)); } }
        }
    }
#pragma unroll
    for (int d = 0; d < HD; ++d) { const float g = bf2f(G[rowq + d]); O[rowq + d] = (bf16)f2bf(o[d] * g / (1.f + expf(-g))); }
}

__device__ __forceinline__ int t5_bucket(int n) {
    if (n < 16) return n;
    const int thr[15] = {19, 21, 24, 27, 31, 35, 40, 46, 52, 59, 67, 77, 87, 99, 113};
    int bk = 16;
#pragma unroll
    for (int i = 0; i < 15; ++i) bk += (n >= thr[i]) ? 1 : 0;
    return bk;
}
__global__ void __launch_bounds__(256) k_moba(const bf16* __restrict__ Q, const bf16* __restrict__ Kb, const bf16* __restrict__ Vb, const bf16* __restrict__ G, const float* __restrict__ KM,
                                               const float* __restrict__ rel, bf16* __restrict__ O) {
    __shared__ float tb[32];
    const int blk = blockIdx.x, ob = blk % NB, bh = blk / NB, b = bh / H, h = bh % H;
    if (threadIdx.x < 32) tb[threadIdx.x] = rel[threadIdx.x * H + h] * LOG2E;
    __syncthreads();
    const int t = ob * MB + threadIdx.x;
    const size_t rowq = (size_t)(b * SEQ + t) * D + h * HD;
    float q[HD], o[HD];
#pragma unroll
    for (int d = 0; d < HD; ++d) { q[d] = bf2f(Q[rowq + d]); o[d] = 0.f; }
    unsigned sel = 0u;
    if (ob <= 3) sel = (1u << ob) - 1u;
    else {
        float v0 = -INFINITY, v1 = -INFINITY, v2 = -INFINITY; int i0 = 31, i1 = 31, i2 = 31;
        for (int n = 0; n < ob; ++n) {
            const float* km = KM + ((size_t)bh * NB + n) * HD; float g = 0.f;
#pragma unroll
            for (int d = 0; d < HD; ++d) g += q[d] * km[d];
            if (g > v0) { v2 = v1; i2 = i1; v1 = v0; i1 = i0; v0 = g; i0 = n; }
            else if (g > v1) { v2 = v1; i2 = i1; v1 = g; i1 = n; }
            else if (g > v2) { v2 = g; i2 = n; }
        }
        sel = (1u << i0) | (1u << i1) | (1u << i2);
    }
    float m = -INFINITY, l = 0.f;
    for (int step = 0; step <= ob; ++step) {
        const int n = (step == 0) ? ob : step - 1;
        const bool bsel = (n == ob) || ((sel >> n) & 1u);
        for (int i = 0; i < MB; ++i) {
            const int s = n * MB + i;
            const size_t rowk = (size_t)(b * SEQ + s) * D + h * HD;
            const uint4* kp = (const uint4*)(Kb + rowk); const uint4* vp = (const uint4*)(Vb + rowk);
            if (bsel && s <= t) {
                float u = 0.f;
#pragma unroll
                for (int j = 0; j < 8; ++j) { const uint4 kk = kp[j]; const unsigned w[4] = {kk.x, kk.y, kk.z, kk.w};
#pragma unroll
                    for (int ii = 0; ii < 4; ++ii) { u += q[8 * j + 2 * ii] * bf2f((unsigned short)(w[ii] & 0xffff)); u += q[8 * j + 2 * ii + 1] * bf2f((unsigned short)(w[ii] >> 16)); } }
                const float x = u + tb[t5_bucket(t - s)];
                if (x > m) { const float sc = exp2f(m - x); l *= sc;
#pragma unroll
                    for (int d = 0; d < HD; ++d) o[d] *= sc;
                    m = x; }
                const float p = exp2f(x - m); l += p;
#pragma unroll
                for (int j = 0; j < 8; ++j) { const uint4 vv = vp[j]; const unsigned ww[4] = {vv.x, vv.y, vv.z, vv.w};
#pragma unroll
                    for (int ii = 0; ii < 4; ++ii) { o[8 * j + 2 * ii] += p * bf2f((unsigned short)(ww[ii] & 0xffff)); o[8 * j + 2 * ii + 1] += p * bf2f((unsigned short)(ww[ii] >> 16)); } }
            }
        }
    }
    const float rl = 1.f / l;
#pragma unroll
    for (int d = 0; d < HD; ++d) { const float g = bf2f(G[rowq + d]); O[rowq + d] = (bf16)f2bf(o[d] * rl * g / (1.f + expf(-g))); }
}

__global__ void __launch_bounds__(256) k_ln(const float* res, const float* __restrict__ Y, const float* __restrict__ g, const float* __restrict__ bta, float* out, bf16* __restrict__ xn) {
    __shared__ float red[8];
    const int row = blockIdx.x, tid = threadIdx.x;
    const float4 r = ((const float4*)(res + (size_t)row * D))[tid], y = ((const float4*)(Y + (size_t)row * D))[tid];
    float v[4] = {ALPHA * r.x + y.x, ALPHA * r.y + y.y, ALPHA * r.z + y.z, ALPHA * r.w + y.w};
    float s = v[0] + v[1] + v[2] + v[3];
    for (int o = 32; o > 0; o >>= 1) s += __shfl_xor(s, o);
    if ((tid & 63) == 0) red[tid >> 6] = s;
    __syncthreads();
    const float mean = (red[0] + red[1] + red[2] + red[3]) * (1.f / D);
    float q = 0.f;
#pragma unroll
    for (int i = 0; i < 4; ++i) { v[i] -= mean; q += v[i] * v[i]; }
    for (int o = 32; o > 0; o >>= 1) q += __shfl_xor(q, o);
    if ((tid & 63) == 0) red[4 + (tid >> 6)] = q;
    __syncthreads();
    const float rstd = 1.f / sqrtf((red[4] + red[5] + red[6] + red[7]) * (1.f / D) + LN_EPS);
    const float4 gg = ((const float4*)g)[tid], bb = ((const float4*)bta)[tid];
    float4 ov; ov.x = v[0] * rstd * gg.x + bb.x; ov.y = v[1] * rstd * gg.y + bb.y; ov.z = v[2] * rstd * gg.z + bb.z; ov.w = v[3] * rstd * gg.w + bb.w;
    ((float4*)(out + (size_t)row * D))[tid] = ov;
    if (xn) { uint2 w; w.x = f2bf(ov.x) | (f2bf(ov.y) << 16); w.y = f2bf(ov.z) | (f2bf(ov.w) << 16); ((uint2*)(xn + (size_t)row * D))[tid] = w; }
}

extern "C" void kernel_launch(void* const* d_in, const int* in_sizes, int n_in, void* d_out, int out_size, void* d_ws, size_t ws_size, hipStream_t stream) {
    if (n_in != 6 || in_sizes[0] != M * D || out_size != M * D || ws_size < WS_END) { fprintf(stderr, "kernel_launch: unexpected shapes (n_in %d, in0 %d, out %d, ws %zu)\n", n_in, n_in > 0 ? in_sizes[0] : -1, out_size, ws_size); return; }
    const float* x = (const float*)d_in[0]; const float* w_in = (const float*)d_in[1]; const float* w_out = (const float*)d_in[2];
    const float* ln_g = (const float*)d_in[3]; const float* ln_b = (const float*)d_in[4]; const float* rel = (const float*)d_in[5];
    float* out = (float*)d_out; unsigned char* ws = (unsigned char*)d_ws;
    bf16 *Win0 = (bf16*)(ws + WS_WIN0), *Win1 = (bf16*)(ws + WS_WIN1), *Wo0 = (bf16*)(ws + WS_WO0), *Wo1 = (bf16*)(ws + WS_WO1);
    bf16 *Qb = (bf16*)(ws + WS_Q), *Kb = (bf16*)(ws + WS_K), *Vb = (bf16*)(ws + WS_V), *Gb = (bf16*)(ws + WS_G), *XN = (bf16*)(ws + WS_XN), *Ob = (bf16*)(ws + WS_O);
    float* KM = (float*)(ws + WS_KM); float* Y = (float*)(ws + WS_Y);
    k_cvt<<<2048, 256, 0, stream>>>(x, XN, (size_t)M * D / 4);
    k_transpose<<<dim3(NPROJ / 32, D / 32), 256, 0, stream>>>(w_in, D, NPROJ, Win0);
    k_transpose<<<dim3(NPROJ / 32, D / 32), 256, 0, stream>>>(w_in + (size_t)D * NPROJ, D, NPROJ, Win1);
    k_transpose<<<dim3(D / 32, D / 32), 256, 0, stream>>>(w_out, D, D, Wo0);
    k_transpose<<<dim3(D / 32, D / 32), 256, 0, stream>>>(w_out + (size_t)D * D, D, D, Wo1);
    const size_t tstride = (WS_K - WS_Q) / 2;
    k_gemm<0><<<dim3(NPROJ / 64, M / 64), 256, 0, stream>>>(XN, Win0, M, NPROJ, D, Qb, tstride, nullptr);
    k_sb<<<BATCH * H * NB, 256, 0, stream>>>(Qb, Kb, Vb, Gb, Ob);
    k_gemm<1><<<dim3(D / 64, M / 64), 256, 0, stream>>>(Ob, Wo0, M, D, D, nullptr, 0, Y);
    k_ln<<<M, 256, 0, stream>>>(x, Y, ln_g, ln_b, out, XN);
    k_gemm<0><<<dim3(NPROJ / 64, M / 64), 256, 0, stream>>>(XN, Win1, M, NPROJ, D, Qb, tstride, nullptr);
    k_kmean<<<BATCH * H * NB, 64, 0, stream>>>(Kb, KM);
    k_moba<<<BATCH * H * NB, 256, 0, stream>>>(Qb, Kb, Vb, Gb, KM, rel, Ob);
    k_gemm<1><<<dim3(D / 64, M / 64), 256, 0, stream>>>(Ob, Wo1, M, D, D, nullptr, 0, Y);
    k_ln<<<M, 256, 0, stream>>>(out, Y, ln_g + D, ln_b + D, out, nullptr);
}
```
